# Optimizing an MI355X kernel written in HIP

```python
import jax, jax.numpy as jnp
from jax import lax
import numpy as np

D_MODEL = 1024
BATCH = 4
SEQ = 4096
DEPTH = 2
DEC_BATCH = 128
DEC_SEQ = 4
PAST_LEN = 8192
PAGE_SIZE = 128

A_WIDTH = D_MODEL // 4
CONV_W = 3
HEAD_DIM = 64
N_Q = (D_MODEL // 2) // HEAD_DIM
N_KV = 2
Q_PER_KV = N_Q // N_KV
B_WIDTH = N_Q * HEAD_DIM
KV_WIDTH = N_KV * HEAD_DIM
WINDOW = 128
CHUNK = 128
C_GROUPS = 4
C_WIDTH = D_MODEL // 4
C_GDIM = C_WIDTH // C_GROUPS
N_BRANCH = 3
D_FF = 2816
FFN_CONV_W = 3
EPS = 1e-6
NEG = -1e30

SPLITS = (A_WIDTH, A_WIDTH, A_WIDTH, B_WIDTH, KV_WIDTH, KV_WIDTH, C_WIDTH, C_WIDTH, N_BRANCH * D_MODEL)
PROJ_WIDTH = sum(SPLITS)
SPLIT_IDX = tuple(int(s) for s in np.cumsum(SPLITS)[:-1])

kernel_name = 'hybrid_gated_conv_swa_chunkmlp_step'


def rmsnorm(x, g):
    xf = x.astype(jnp.float32)
    y = xf * lax.rsqrt(jnp.mean(xf * xf, axis=-1, keepdims=True) + EPS)
    return (y * g.astype(jnp.float32)).astype(x.dtype)


def causal_dwconv(z, prev, w, b=None):
    width = w.shape[0]
    t = z.shape[1]
    full = jnp.concatenate([prev.astype(z.dtype), z], axis=1)
    y = sum(w[i] * full[:, i:i + t] for i in range(width))
    if b is not None:
        y = y + b
    return y, full[:, full.shape[1] - (width - 1):]


def sink_softmax(s, sinks):
    sk = sinks.astype(jnp.float32)[..., None, None]
    m = jnp.maximum(jnp.max(s, axis=-1, keepdims=True), sk)
    p = jnp.exp(s - m)
    return p / (jnp.sum(p, axis=-1, keepdims=True) + jnp.exp(sk - m))


def window_attn_prompt(q, k, v, sinks):
    bsz, s_len = q.shape[0], q.shape[1]
    nb = s_len // WINDOW
    qb = q.reshape(bsz, nb, WINDOW, N_KV, Q_PER_KV, HEAD_DIM)
    kb = k.reshape(bsz, nb, WINDOW, N_KV, HEAD_DIM)
    vb = v.reshape(bsz, nb, WINDOW, N_KV, HEAD_DIM)
    kk = jnp.concatenate([jnp.concatenate([jnp.zeros_like(kb[:, :1]), kb[:, :-1]], axis=1), kb], axis=2)
    vv = jnp.concatenate([jnp.concatenate([jnp.zeros_like(vb[:, :1]), vb[:, :-1]], axis=1), vb], axis=2)
    s = jnp.einsum('bnqhgd,bnkhd->bnhgqk', qb, kk, preferred_element_type=jnp.float32) * (HEAD_DIM ** -0.5)
    i = jnp.arange(WINDOW)[:, None]
    j = jnp.arange(2 * WINDOW)[None, :]
    diff = i + WINDOW - j
    band = (diff >= 0) & (diff < WINDOW)
    has_prev = jnp.arange(nb)[:, None, None] > 0
    mask = band[None] & (has_prev | (j >= WINDOW)[None])
    p = sink_softmax(jnp.where(mask[None, :, None, None], s, NEG), sinks)
    o = jnp.einsum('bnhgqk,bnkhd->bnqhgd', p.astype(vv.dtype), vv)
    rows = min(WINDOW, s_len)
    return o.reshape(bsz, s_len, B_WIDTH), k[:, s_len - rows:], v[:, s_len - rows:]


def window_attn_sample(q, k, v, ck, cv, sinks):
    bsz, t = q.shape[0], q.shape[1]
    r = ck.shape[1]
    kk = jnp.concatenate([ck.astype(k.dtype), k], axis=1)
    vv = jnp.concatenate([cv.astype(v.dtype), v], axis=1)
    qg = q.reshape(bsz, t, N_KV, Q_PER_KV, HEAD_DIM)
    s = jnp.einsum('bqhgd,bkhd->bhgqk', qg, kk, preferred_element_type=jnp.float32) * (HEAD_DIM ** -0.5)
    diff = jnp.arange(t)[:, None] + r - jnp.arange(r + t)[None, :]
    mask = (diff >= 0) & (diff < WINDOW)
    p = sink_softmax(jnp.where(mask, s, NEG), sinks)
    o = jnp.einsum('bhgqk,bkhd->bqhgd', p.astype(vv.dtype), vv)
    return o.reshape(bsz, t, B_WIDTH), kk[:, t:], vv[:, t:]


def chunk_spatial_gate(u, v, w_s, b_s):
    L = v.shape[2]
    tri = jnp.tril(jnp.ones((L, L), dtype=bool))
    w = jnp.where(tri, w_s[:, :L, :L], jnp.zeros((), w_s.dtype))
    mixed = jnp.einsum('gts,bnsgc->bntgc', w, v) + b_s[:, :L].T[None, None, :, :, None]
    return u * mixed


def hybrid_layer(x, conv_a_prev, win_k, win_v, ffn_prev,
                 w_in, conv_a_w, sinks, w_s, b_s, g_v, w_ba, w_bb, w_bc, w_o,
                 g_pre, g_post, g_pre_f, g_post_f, w_up, conv_f_w, conv_f_b, w_down):
    bsz, t, _ = x.shape
    h = rmsnorm(x, g_pre)
    p = h @ w_in
    a_in, a_b, a_c, q, k, v, c_u, c_v, gates = jnp.split(p, SPLIT_IDX, axis=-1)
    za, conv_a_new = causal_dwconv(a_c * a_in, conv_a_prev, conv_a_w)
    ya = a_b * za
    q = q.reshape(bsz, t, N_Q, HEAD_DIM)
    k = k.reshape(bsz, t, N_KV, HEAD_DIM)
    v = v.reshape(bsz, t, N_KV, HEAD_DIM)
    if win_k is None:
        yb, k_new, v_new = window_attn_prompt(q, k, v, sinks)
    else:
        yb, k_new, v_new = window_attn_sample(q, k, v, win_k, win_v, sinks)
    L = min(t, CHUNK)
    n = t // L
    vn = rmsnorm(c_v, g_v)
    yc = chunk_spatial_gate(c_u.reshape(bsz, n, L, C_GROUPS, C_GDIM),
                            vn.reshape(bsz, n, L, C_GROUPS, C_GDIM), w_s, b_s).reshape(bsz, t, C_WIDTH)
    g = jax.nn.sigmoid(gates.astype(jnp.float32)).astype(x.dtype).reshape(bsz, t, N_BRANCH, D_MODEL)
    merged = g[:, :, 0] * (ya @ w_ba) + g[:, :, 1] * (yb @ w_bb) + g[:, :, 2] * (yc @ w_bc)
    x = x + rmsnorm(merged @ w_o, g_post)
    up = rmsnorm(x, g_pre_f) @ w_up
    upc, ffn_new = causal_dwconv(up, ffn_prev, conv_f_w, conv_f_b)
    fa, fb = jnp.split(upc, 2, axis=-1)
    x = x + rmsnorm((jax.nn.silu(fa) * fb) @ w_down, g_post_f)
    return x, conv_a_new, k_new, v_new, ffn_new, vn


def setup_inputs(seed: int = 0) -> dict:
    key = jax.random.key(seed)
    ks = iter(jax.random.split(key, 32))
    f32 = jnp.float32
    nrm = lambda shape, scale: jax.random.normal(next(ks), shape, f32) * scale
    win_rows = min(WINDOW, PAST_LEN)
    return {
        'x_prompt': nrm((BATCH, SEQ, D_MODEL), 1.0),
        'x_sample': nrm((DEC_BATCH, DEC_SEQ, D_MODEL), 1.0),
        'state_conv_a': nrm((DEPTH, DEC_BATCH, CONV_W - 1, A_WIDTH), 1.0),
        'cache_win_k': nrm((DEPTH, DEC_BATCH, win_rows, N_KV, HEAD_DIM), 1.0),
        'cache_win_v': nrm((DEPTH, DEC_BATCH, win_rows, N_KV, HEAD_DIM), 1.0),
        'state_ffn_conv': nrm((DEPTH, DEC_BATCH, FFN_CONV_W - 1, 2 * D_FF), 1.0),
        'w_in': nrm((DEPTH, D_MODEL, PROJ_WIDTH), D_MODEL ** -0.5),
        'conv_a_w': nrm((DEPTH, CONV_W, A_WIDTH), CONV_W ** -0.5),
        'attn_sinks': nrm((DEPTH, N_KV, Q_PER_KV), 1.0),
        'spatial_w': nrm((DEPTH, C_GROUPS, CHUNK, CHUNK), CHUNK ** -0.5),
        'spatial_b': 1.0 + nrm((DEPTH, C_GROUPS, CHUNK), 0.1),
        'g_v': 1.0 + nrm((DEPTH, C_WIDTH), 0.05),
        'w_branch_a': nrm((DEPTH, A_WIDTH, D_MODEL), A_WIDTH ** -0.5),
        'w_branch_b': nrm((DEPTH, B_WIDTH, D_MODEL), B_WIDTH ** -0.5),
        'w_branch_c': nrm((DEPTH, C_WIDTH, D_MODEL), C_WIDTH ** -0.5),
        'w_out': nrm((DEPTH, D_MODEL, D_MODEL), D_MODEL ** -0.5),
        'g_pre_mix': 1.0 + nrm((DEPTH, D_MODEL), 0.05),
        'g_post_mix': 1.0 + nrm((DEPTH, D_MODEL), 0.05),
        'g_pre_ffn': 1.0 + nrm((DEPTH, D_MODEL), 0.05),
        'g_post_ffn': 1.0 + nrm((DEPTH, D_MODEL), 0.05),
        'w_up': nrm((DEPTH, D_MODEL, 2 * D_FF), D_MODEL ** -0.5),
        'conv_ffn_w': nrm((DEPTH, FFN_CONV_W, 2 * D_FF), FFN_CONV_W ** -0.5),
        'conv_ffn_b': nrm((DEPTH, 2 * D_FF), 0.01),
        'w_down': nrm((DEPTH, D_FF, D_MODEL), D_FF ** -0.5),
    }


def reference(x_prompt, x_sample, state_conv_a, cache_win_k, cache_win_v, state_ffn_conv,
              w_in, conv_a_w, attn_sinks, spatial_w, spatial_b, g_v, w_branch_a, w_branch_b,
              w_branch_c, w_out, g_pre_mix, g_post_mix, g_pre_ffn, g_post_ffn, w_up,
              conv_ffn_w, conv_ffn_b, w_down):
    yp, ys = x_prompt, x_sample
    bp = x_prompt.shape[0]
    ca_p, wk_p, wv_p, ff_p = [], [], [], []
    ca_s, wk_s, wv_s, ff_s, cv_s = [], [], [], [], []
    for l in range(DEPTH):
        wts = (w_in[l], conv_a_w[l], attn_sinks[l], spatial_w[l], spatial_b[l], g_v[l],
               w_branch_a[l], w_branch_b[l], w_branch_c[l], w_out[l], g_pre_mix[l], g_post_mix[l],
               g_pre_ffn[l], g_post_ffn[l], w_up[l], conv_ffn_w[l], conv_ffn_b[l], w_down[l])
        zeros_a = jnp.zeros((bp, CONV_W - 1, A_WIDTH), yp.dtype)
        zeros_f = jnp.zeros((bp, FFN_CONV_W - 1, 2 * D_FF), yp.dtype)
        yp, ca, k_new, v_new, ff, _ = hybrid_layer(yp, zeros_a, None, None, zeros_f, *wts)
        ca_p.append(ca); wk_p.append(k_new); wv_p.append(v_new); ff_p.append(ff)
        ys, ca, k_new, v_new, ff, vn = hybrid_layer(ys, state_conv_a[l], cache_win_k[l], cache_win_v[l],
                                                    state_ffn_conv[l], *wts)
        ca_s.append(ca); wk_s.append(k_new); wv_s.append(v_new); ff_s.append(ff); cv_s.append(vn)
    return (yp, ys,
            jnp.stack(ca_p), jnp.stack(wk_p), jnp.stack(wv_p), jnp.stack(ff_p),
            jnp.stack(ca_s), jnp.stack(wk_s), jnp.stack(wv_s), jnp.stack(ff_s), jnp.stack(cv_s))
```

```cpp
#include <hip/hip_runtime.h>
#include <cstdio>
#include <cstdint>

constexpr int D = 1024, NB = 4, SEQ = 4096, DEPTH = 2, DB = 128, DS = 4;
constexpr int MP = NB * SEQ, MS = DB * DS, M = MP + MS;
constexpr int AW = 256, HD = 64, NQ = 8, NKV = 2, BW = 512, KVW = 128, WIN = 128, CH = 128, CG = 4, CW = 256, CGD = 64;
constexpr int FF = 2816, FF2 = 5632, PW = 5120;
constexpr float EPS = 1e-6f;
constexpr int PC_AIN = 0, PC_AB = 256, PC_AC = 512, PC_Q = 768, PC_K = 1280, PC_V = 1408, PC_CU = 1536, PC_CV = 1792, PC_G = 2048;
constexpr size_t O_YP = 0, O_YS = O_YP + (size_t)MP * D, O_CAP = O_YS + (size_t)MS * D, O_WKP = O_CAP + 2 * 4 * 2 * 256, O_WVP = O_WKP + 2 * 4 * 128 * 128,
                 O_FCP = O_WVP + 2 * 4 * 128 * 128, O_CAS = O_FCP + 2 * 4 * 2 * 5632, O_WKS = O_CAS + 2 * 128 * 2 * 256, O_WVS = O_WKS + (size_t)2 * 128 * 128 * 128,
                 O_FCS = O_WVS + (size_t)2 * 128 * 128 * 128, O_CVS = O_FCS + (size_t)2 * 128 * 2 * 5632, O_END = O_CVS + 2 * 128 * 4 * 256;

struct Ptrs {
    const float *x_prompt, *x_sample, *state_conv_a, *cache_k, *cache_v, *state_ffn, *w_in, *conv_a_w, *sinks, *spatial_w, *spatial_b, *g_v,
        *w_ba, *w_bb, *w_bc, *w_out, *g_pre_mix, *g_post_mix, *g_pre_ffn, *g_post_ffn, *w_up, *conv_ffn_w, *conv_ffn_b, *w_down;
    float* out;
};

__device__ __forceinline__ float wave_sum(float v) {
#pragma unroll
    for (int o = 1; o < 64; o <<= 1) v += __shfl_xor(v, o);
    return v;
}
__global__ void k_rmsnorm(const float* x, int ldx, const float* g, float* out, int ldo, int rows, int ncols) {
    const int w = (blockIdx.x * blockDim.x + threadIdx.x) >> 6, lane = threadIdx.x & 63;
    if (w >= rows) return;
    const float* xr = x + (size_t)w * ldx; float s = 0.f;
    for (int c = lane; c < ncols; c += 64) { const float v = xr[c]; s += v * v; }
    s = wave_sum(s);
    const float rs = 1.0f / sqrtf(s / (float)ncols + EPS);
    float* o = out + (size_t)w * ldo;
    for (int c = lane; c < ncols; c += 64) o[c] = xr[c] * rs * g[c];
}
__global__ void k_res_norm(float* x, const float* d, const float* g, int rows) {
    const int w = (blockIdx.x * blockDim.x + threadIdx.x) >> 6, lane = threadIdx.x & 63;
    if (w >= rows) return;
    const float* dr = d + (size_t)w * D; float s = 0.f;
    for (int c = lane; c < D; c += 64) { const float v = dr[c]; s += v * v; }
    s = wave_sum(s);
    const float rs = 1.0f / sqrtf(s / (float)D + EPS);
    float* xr = x + (size_t)w * D;
    for (int c = lane; c < D; c += 64) xr[c] += dr[c] * rs * g[c];
}
__global__ void __launch_bounds__(256) k_gemm(const float* A, int lda, const float* W, int ldw, float* C, int ldc, int K) {
    __shared__ float As[16][128 + 4];
    __shared__ float Ws[16][128 + 4];
    const int tid = threadIdx.x, tx = tid & 15, ty = tid >> 4;
    const int m0 = blockIdx.y * 128, n0 = blockIdx.x * 128;
    float acc[8][8];
#pragma unroll
    for (int i = 0; i < 8; ++i)
#pragma unroll
        for (int j = 0; j < 8; ++j) acc[i][j] = 0.f;
    for (int k0 = 0; k0 < K; k0 += 16) {
#pragma unroll
        for (int i = 0; i < 8; ++i) { const int e = tid + i * 256, r = e >> 4, kk = e & 15; As[kk][r] = A[(size_t)(m0 + r) * lda + k0 + kk]; }
#pragma unroll
        for (int i = 0; i < 8; ++i) { const int e = tid + i * 256, kk = e >> 7, c = e & 127; Ws[kk][c] = W[(size_t)(k0 + kk) * ldw + n0 + c]; }
        __syncthreads();
#pragma unroll
        for (int kk = 0; kk < 16; ++kk) {
            float a[8], b[8];
#pragma unroll
            for (int i = 0; i < 8; ++i) a[i] = As[kk][ty * 8 + i];
#pragma unroll
            for (int j = 0; j < 8; ++j) b[j] = Ws[kk][tx * 8 + j];
#pragma unroll
            for (int i = 0; i < 8; ++i)
#pragma unroll
                for (int j = 0; j < 8; ++j) acc[i][j] = fmaf(a[i], b[j], acc[i][j]);
        }
        __syncthreads();
    }
#pragma unroll
    for (int i = 0; i < 8; ++i)
#pragma unroll
        for (int j = 0; j < 8; ++j) C[(size_t)(m0 + ty * 8 + i) * ldc + n0 + tx * 8 + j] = acc[i][j];
}
__device__ __forceinline__ void row_info(int m, bool& smp, int& b, int& t) { smp = m >= MP; if (smp) { const int s = m - MP; b = s >> 2; t = s & 3; } else { b = m >> 12; t = m & 4095; } }

__global__ void k_convA(const float* P, float* y, int r0, int nr, int layer, Ptrs p) {
    const int idx = blockIdx.x * blockDim.x + threadIdx.x; if (idx >= nr * AW) return;
    const int r = idx / AW, c = idx % AW, m = r0 + r; bool smp; int b, t; row_info(m, smp, b, t);
    const float* cw = p.conv_a_w + (size_t)layer * 3 * AW;
    auto z = [&](int rr) { return P[(size_t)rr * PW + PC_AC + c] * P[(size_t)rr * PW + PC_AIN + c]; };
    float z0 = z(r), z1, z2;
    if (!smp) { z1 = t >= 1 ? z(r - 1) : 0.f; z2 = t >= 2 ? z(r - 2) : 0.f; }
    else { const float* st = p.state_conv_a + ((size_t)layer * DB + b) * 2 * AW;
        z1 = t >= 1 ? z(r - 1) : st[1 * AW + c]; z2 = t >= 2 ? z(r - 2) : st[(t) * AW + c]; }
    const float za = cw[0 * AW + c] * z2 + cw[1 * AW + c] * z1 + cw[2 * AW + c] * z0;
    y[(size_t)r * D + c] = P[(size_t)r * PW + PC_AB + c] * za;
    if (!smp) { if (t >= SEQ - 2) p.out[O_CAP + (((size_t)layer * NB + b) * 2 + (t - (SEQ - 2))) * AW + c] = z0; }
    else { if (t >= 2) p.out[O_CAS + (((size_t)layer * DB + b) * 2 + (t - 2)) * AW + c] = z0; }
}
__global__ void k_vn(const float* P, float* vn, int r0, int nr, int layer, Ptrs p) {
    const int w = (blockIdx.x * blockDim.x + threadIdx.x) >> 6, lane = threadIdx.x & 63; if (w >= nr) return;
    const float* cv = P + (size_t)w * PW + PC_CV; float s = 0.f;
    for (int c = lane; c < CW; c += 64) s += cv[c] * cv[c];
    s = wave_sum(s); const float rs = 1.0f / sqrtf(s / (float)CW + EPS);
    const int m = r0 + w; bool smp; int b, t; row_info(m, smp, b, t);
    for (int c = lane; c < CW; c += 64) { const float v = cv[c] * rs * p.g_v[layer * CW + c]; vn[(size_t)w * CW + c] = v;
        if (smp) p.out[O_CVS + (((size_t)layer * DB + b) * DS + t) * CW + c] = v; }
}
__global__ void k_chunk(const float* P, const float* vn, float* y, int r0, int nr, int layer, Ptrs p) {
    const int idx = blockIdx.x * blockDim.x + threadIdx.x; if (idx >= nr * CW) return;
    const int r = idx / CW, c = idx % CW, m = r0 + r, g = c / CGD; bool smp; int b, t; row_info(m, smp, b, t);
    const int tt = smp ? t : (t & (CH - 1));
    const float* ws = p.spatial_w + (((size_t)layer * CG + g) * CH + tt) * CH;
    float acc = 0.f;
    for (int s = 0; s <= tt; ++s) acc = fmaf(ws[s], vn[(size_t)(r - tt + s) * CW + c], acc);
    acc += p.spatial_b[((size_t)layer * CG + g) * CH + tt];
    y[(size_t)r * D + 768 + c] = P[(size_t)r * PW + PC_CU + c] * acc;
}
__global__ void __launch_bounds__(64) k_attn(const float* P, float* y, int r0, int nr, int layer, Ptrs p) {
    const int idx = blockIdx.x * blockDim.x + threadIdx.x; if (idx >= nr * NQ) return;
    const int r = idx % nr, h = idx / nr, m = r0 + r, kv = h >> 2; bool smp; int b, t; row_info(m, smp, b, t);
    float q[HD], o[HD];
#pragma unroll
    for (int d = 0; d < HD; ++d) { q[d] = P[(size_t)r * PW + PC_Q + h * HD + d] * 0.125f; o[d] = 0.f; }
    const float sink = p.sinks[((size_t)layer * NKV + kv) * 4 + (h & 3)];
    float mx = sink, l = 0.f;
    const int nkeys = smp ? 128 : (t < 127 ? t + 1 : 128);
    for (int jj = 0; jj < nkeys; ++jj) {
        const float *kp, *vp;
        if (!smp) { const int rr = r - (nkeys - 1) + jj; kp = P + (size_t)rr * PW + PC_K + kv * HD; vp = P + (size_t)rr * PW + PC_V + kv * HD; }
        else { const int j = t + 1 + jj;
            if (j < 128) { kp = p.cache_k + ((((size_t)layer * DB + b) * 128 + j) * NKV + kv) * HD; vp = p.cache_v + ((((size_t)layer * DB + b) * 128 + j) * NKV + kv) * HD; }
            else { const int rr = r - t + (j - 128); kp = P + (size_t)rr * PW + PC_K + kv * HD; vp = P + (size_t)rr * PW + PC_V + kv * HD; } }
        float s = 0.f;
#pragma unroll
        for (int d = 0; d < HD; ++d) s = fmaf(q[d], kp[d], s);
        const float mn = fmaxf(mx, s), al = __expf(mx - mn), pj = __expf(s - mn);
        l = l * al + pj; mx = mn;
#pragma unroll
        for (int d = 0; d < HD; ++d) o[d] = o[d] * al + pj * vp[d];
    }
    const float inv = 1.0f / (l + __expf(sink - mx));
#pragma unroll
    for (int d = 0; d < HD; ++d) y[(size_t)r * D + 256 + h * HD + d] = o[d] * inv;
}
__global__ void k_wincache(const float* P, int r0, int nr, int layer, Ptrs p) {
    const int idx = blockIdx.x * blockDim.x + threadIdx.x; if (idx >= nr * KVW) return;
    const int r = idx / KVW, c = idx % KVW, m = r0 + r; bool smp; int b, t; row_info(m, smp, b, t);
    const float kx = P[(size_t)r * PW + PC_K + c], vx = P[(size_t)r * PW + PC_V + c];
    if (!smp) { if (t >= SEQ - WIN) { const size_t o = (((size_t)layer * NB + b) * WIN + (t - (SEQ - WIN))) * KVW + c; p.out[O_WKP + o] = kx; p.out[O_WVP + o] = vx; } }
    else { const size_t o = (((size_t)layer * DB + b) * WIN + (124 + t)) * KVW + c; p.out[O_WKS + o] = kx; p.out[O_WVS + o] = vx; }
}
__global__ void k_wincache_old(int layer, Ptrs p) {
    const int idx = blockIdx.x * blockDim.x + threadIdx.x; if (idx >= DB * 124 * KVW) return;
    const int c = idx % KVW, j = (idx / KVW) % 124, b = idx / (KVW * 124);
    const size_t src = (((size_t)layer * DB + b) * WIN + (j + 4)) * KVW + c, dst = (((size_t)layer * DB + b) * WIN + j) * KVW + c;
    p.out[O_WKS + dst] = p.cache_k[src]; p.out[O_WVS + dst] = p.cache_v[src];
}
__global__ void k_merge(const float* P, const float* Ya, const float* Yb, const float* Yc, float* mg, int nr) {
    const int idx = blockIdx.x * blockDim.x + threadIdx.x; if (idx >= nr * D) return;
    const int r = idx / D, c = idx % D; const float* g = P + (size_t)r * PW + PC_G;
    auto sg = [](float v) { return 1.0f / (1.0f + __expf(-v)); };
    mg[idx] = sg(g[c]) * Ya[idx] + sg(g[D + c]) * Yb[idx] + sg(g[2 * D + c]) * Yc[idx];
}
__global__ void k_ffnact(const float* up, float* act, int r0, int nr, int layer, Ptrs p) {
    const int idx = blockIdx.x * blockDim.x + threadIdx.x; if (idx >= nr * FF) return;
    const int r = idx / FF, j = idx % FF, m = r0 + r; bool smp; int b, t; row_info(m, smp, b, t);
    const float* cw = p.conv_ffn_w + (size_t)layer * 3 * FF2; const float* cb = p.conv_ffn_b + (size_t)layer * FF2;
    float res[2];
#pragma unroll
    for (int hh = 0; hh < 2; ++hh) { const int c = j + hh * FF;
        const float u0 = up[(size_t)r * FF2 + c]; float u1, u2;
        if (!smp) { u1 = t >= 1 ? up[(size_t)(r - 1) * FF2 + c] : 0.f; u2 = t >= 2 ? up[(size_t)(r - 2) * FF2 + c] : 0.f; }
        else { const float* st = p.state_ffn + ((size_t)layer * DB + b) * 2 * FF2; u1 = t >= 1 ? up[(size_t)(r - 1) * FF2 + c] : st[FF2 + c]; u2 = t >= 2 ? up[(size_t)(r - 2) * FF2 + c] : st[(size_t)t * FF2 + c]; }
        res[hh] = cw[c] * u2 + cw[FF2 + c] * u1 + cw[2 * FF2 + c] * u0 + cb[c];
        if (!smp) { if (t >= SEQ - 2) p.out[O_FCP + (((size_t)layer * NB + b) * 2 + (t - (SEQ - 2))) * FF2 + c] = u0; }
        else { if (t >= 2) p.out[O_FCS + (((size_t)layer * DB + b) * 2 + (t - 2)) * FF2 + c] = u0; } }
    const float a = res[0]; act[idx] = (a / (1.0f + __expf(-a))) * res[1];
}

static void v1_forward(const Ptrs& p, float* ws, hipStream_t st) {
    hipMemcpyAsync(p.out + O_YP, p.x_prompt, (size_t)MP * D * 4, hipMemcpyDeviceToDevice, st);
    hipMemcpyAsync(p.out + O_YS, p.x_sample, (size_t)MS * D * 4, hipMemcpyDeviceToDevice, st);
    float* Pb = ws;
    float* hb = Pb + (size_t)4096 * FF2;
    float* yb = hb + (size_t)4096 * D;
    float* t0 = yb + (size_t)4096 * D;
    float* t1 = t0 + (size_t)4096 * D; float* t2 = t1 + (size_t)4096 * D;
    float* mg = t2 + (size_t)4096 * D;
    float* dd = mg + (size_t)4096 * D;
    float* vn = dd + (size_t)4096 * D;
    for (int l = 0; l < DEPTH; ++l) {
        hipLaunchKernelGGL(k_wincache_old, dim3((DB * 124 * KVW + 255) / 256), dim3(256), 0, st, l, p);
        for (int g = 0; g < 5; ++g) {
            const int r0 = g < 4 ? g * SEQ : MP, nr = g < 4 ? SEQ : MS;
            float* x = p.out + (size_t)r0 * D;
            hipLaunchKernelGGL(k_rmsnorm, dim3(nr / 4), dim3(256), 0, st, x, D, p.g_pre_mix + l * D, hb, D, nr, D);
            hipLaunchKernelGGL(k_gemm, dim3(PW / 128, nr / 128), dim3(256), 0, st, hb, D, p.w_in + (size_t)l * D * PW, PW, Pb, PW, D);
            hipLaunchKernelGGL(k_convA, dim3((nr * AW + 255) / 256), dim3(256), 0, st, Pb, yb, r0, nr, l, p);
            hipLaunchKernelGGL(k_vn, dim3(nr / 4), dim3(256), 0, st, Pb, vn, r0, nr, l, p);
            hipLaunchKernelGGL(k_chunk, dim3((nr * CW + 255) / 256), dim3(256), 0, st, Pb, vn, yb, r0, nr, l, p);
            hipLaunchKernelGGL(k_attn, dim3((nr * NQ + 63) / 64), dim3(64), 0, st, Pb, yb, r0, nr, l, p);
            hipLaunchKernelGGL(k_wincache, dim3((nr * KVW + 255) / 256), dim3(256), 0, st, Pb, r0, nr, l, p);
            hipLaunchKernelGGL(k_gemm, dim3(D / 128, nr / 128), dim3(256), 0, st, yb, D, p.w_ba + (size_t)l * AW * D, D, t0, D, AW);
            hipLaunchKernelGGL(k_gemm, dim3(D / 128, nr / 128), dim3(256), 0, st, yb + 256, D, p.w_bb + (size_t)l * BW * D, D, t1, D, BW);
            hipLaunchKernelGGL(k_gemm, dim3(D / 128, nr / 128), dim3(256), 0, st, yb + 768, D, p.w_bc + (size_t)l * CW * D, D, t2, D, CW);
            hipLaunchKernelGGL(k_merge, dim3((nr * D + 255) / 256), dim3(256), 0, st, Pb, t0, t1, t2, mg, nr);
            hipLaunchKernelGGL(k_gemm, dim3(D / 128, nr / 128), dim3(256), 0, st, mg, D, p.w_out + (size_t)l * D * D, D, dd, D, D);
            hipLaunchKernelGGL(k_res_norm, dim3(nr / 4), dim3(256), 0, st, x, dd, p.g_post_mix + l * D, nr);
            hipLaunchKernelGGL(k_rmsnorm, dim3(nr / 4), dim3(256), 0, st, x, D, p.g_pre_ffn + l * D, hb, D, nr, D);
            hipLaunchKernelGGL(k_gemm, dim3(FF2 / 128, nr / 128), dim3(256), 0, st, hb, D, p.w_up + (size_t)l * D * FF2, FF2, Pb, FF2, D);
            hipLaunchKernelGGL(k_ffnact, dim3((nr * FF + 255) / 256), dim3(256), 0, st, Pb, t0, r0, nr, l, p);
            hipLaunchKernelGGL(k_gemm, dim3(D / 128, nr / 128), dim3(256), 0, st, t0, FF, p.w_down + (size_t)l * FF * D, D, dd, D, FF);
            hipLaunchKernelGGL(k_res_norm, dim3(nr / 4), dim3(256), 0, st, x, dd, p.g_post_ffn + l * D, nr);
        }
    }
}

extern "C" void kernel_launch(void* const* d_in, const int* in_sizes, int n_in, void* d_out, int out_size, void* d_ws, size_t ws_size, hipStream_t stream) {
    Ptrs p{};
    const float** pp = (const float**)&p;
    for (int i = 0; i < 24; ++i) pp[i] = (const float*)d_in[i];
    p.out = (float*)d_out;
    v1_forward(p, (float*)d_ws, stream);
}
```
